# Optimizing an MI355X kernel written in HIP

```python
import jax, jax.numpy as jnp
from jax import lax
import numpy as np

D_MODEL = 1024
BATCH = 8
SEQ = 2048
DEPTH = 1

PLE_DIM = 256
CONV_WIDTH = D_MODEL // 2
CONV_GROUPS = 8
CONV_K = 3
RET_WIDTH = D_MODEL - CONV_WIDTH
RET_HEADS = 4
RET_HEAD_DIM = RET_WIDTH // RET_HEADS
D_FF = 4 * D_MODEL
CHUNK = 128
ROPE_BASE = 10000.0
LN_EPS = 1e-5
GN_EPS = 1e-5
DEEPNORM_ALPHA = (2.0 * DEPTH) ** 0.25
DEEPNORM_BETA = (8.0 * DEPTH) ** -0.25
IN_COLS = 3 * CONV_WIDTH + 4 * RET_WIDTH

kernel_name = "hybrid_conv_retention_deepnorm_layer"


def layer_norm(x, w, b):
    xf = x.astype(jnp.float32)
    mu = jnp.mean(xf, axis=-1, keepdims=True)
    var = jnp.mean(jnp.square(xf - mu), axis=-1, keepdims=True)
    y = (xf - mu) * lax.rsqrt(var + LN_EPS)
    return (y * w.astype(jnp.float32) + b.astype(jnp.float32)).astype(x.dtype)


def rotary(x, positions):
    dh = x.shape[-1]
    half = dh // 2
    inv_freq = ROPE_BASE ** (-jnp.arange(half, dtype=jnp.float32) * 2.0 / dh)
    ang = positions.astype(jnp.float32)[:, :, None] * inv_freq
    cos = jnp.cos(ang)[:, :, None, :]
    sin = jnp.sin(ang)[:, :, None, :]
    xf = x.astype(jnp.float32)
    x1, x2 = xf[..., :half], xf[..., half:]
    out = jnp.concatenate([x1 * cos - x2 * sin, x2 * cos + x1 * sin], axis=-1)
    return out.astype(x.dtype)


def causal_short_conv(u, w):
    s = u.shape[1]
    up = jnp.pad(u, ((0, 0), (CONV_K - 1, 0), (0, 0)))
    return sum(up[:, k:k + s, :] * w[k] for k in range(CONV_K))


def chunkwise_retention(q, k, v):
    bsz, s, h, d = q.shape
    n = s // CHUNK
    dt = q.dtype
    qf = q.astype(jnp.float32).reshape(bsz, n, CHUNK, h, d).transpose(0, 3, 1, 2, 4)
    kf = k.astype(jnp.float32).reshape(bsz, n, CHUNK, h, d).transpose(0, 3, 1, 2, 4)
    vf = v.astype(jnp.float32).reshape(bsz, n, CHUNK, h, d).transpose(0, 3, 1, 2, 4)
    log_g = jnp.log1p(-jnp.exp2(-5.0 - jnp.arange(h, dtype=jnp.float32)))
    idx = jnp.arange(CHUNK, dtype=jnp.float32)
    diff = idx[:, None] - idx[None, :]
    causal = diff >= 0
    decay_mat = jnp.where(causal[None], jnp.exp(jnp.where(causal, diff, 0.0)[None] * log_g[:, None, None]), 0.0)
    scores = jnp.einsum('bhnid,bhnjd->bhnij', qf, kf) * decay_mat[None, :, None]
    inner = jnp.einsum('bhnij,bhnje->bhnie', scores, vf)
    zeta = jnp.exp((CHUNK - 1.0 - idx)[None, :] * log_g[:, None])
    kv = jnp.einsum('bhncd,hc,bhnce->bhnde', kf, zeta, vf)
    chunk_decay = jnp.exp(CHUNK * log_g)[None, :, None, None]

    def step(state, kv_n):
        return state * chunk_decay + kv_n, state

    init = jnp.zeros((bsz, h, d, d), jnp.float32)
    _, prev_states = lax.scan(step, init, jnp.moveaxis(kv, 2, 0))
    prev_states = jnp.moveaxis(prev_states, 0, 2)
    xi = jnp.exp((idx + 1.0)[None, :] * log_g[:, None])
    cross = jnp.einsum('bhncd,hc,bhnde->bhnce', qf, xi, prev_states)
    out = (inner + cross).transpose(0, 2, 3, 1, 4).reshape(bsz, s, h, d)
    return out.astype(dt)


def head_group_norm(o, w, b):
    of = o.astype(jnp.float32)
    mu = jnp.mean(of, axis=-1, keepdims=True)
    var = jnp.mean(jnp.square(of - mu), axis=-1, keepdims=True)
    y = (of - mu) * lax.rsqrt(var + GN_EPS)
    y = y.reshape(o.shape[0], o.shape[1], -1)
    return (y * w.astype(jnp.float32) + b.astype(jnp.float32)).astype(o.dtype)


def setup_inputs(seed: int = 0) -> dict:
    key = jax.random.key(seed)
    ks = jax.random.split(key, 16)
    f32 = jnp.float32
    nrm = lambda k, shape, scale: jax.random.normal(k, shape, f32) * scale
    x = jax.random.normal(ks[0], (BATCH, SEQ, D_MODEL), f32)
    p = jax.random.normal(ks[1], (DEPTH, BATCH, SEQ, PLE_DIM), f32)
    positions = jnp.broadcast_to(jnp.arange(SEQ, dtype=jnp.int32)[None, :], (BATCH, SEQ))
    w_in = nrm(ks[2], (DEPTH, D_MODEL, IN_COLS), D_MODEL ** -0.5)
    conv_w = nrm(ks[3], (DEPTH, CONV_K, CONV_WIDTH), CONV_K ** -0.5)
    ret_gn_w = 1.0 + nrm(ks[4], (DEPTH, RET_WIDTH), 0.02)
    ret_gn_b = nrm(ks[5], (DEPTH, RET_WIDTH), 0.02)
    w_out = nrm(ks[6], (DEPTH, D_MODEL, D_MODEL), D_MODEL ** -0.5 * DEEPNORM_BETA)
    ln1_w = 1.0 + nrm(ks[7], (DEPTH, D_MODEL), 0.02)
    ln1_b = nrm(ks[8], (DEPTH, D_MODEL), 0.02)
    w_ff1 = nrm(ks[9], (DEPTH, D_MODEL, D_FF), D_MODEL ** -0.5)
    w_ff2 = nrm(ks[10], (DEPTH, D_FF, D_MODEL), D_FF ** -0.5 * DEEPNORM_BETA)
    w_ple_gate = nrm(ks[11], (DEPTH, D_MODEL, D_MODEL), D_MODEL ** -0.5)
    w_ple_proj = nrm(ks[12], (DEPTH, PLE_DIM, D_MODEL), PLE_DIM ** -0.5 * DEEPNORM_BETA)
    ln2_w = 1.0 + nrm(ks[13], (DEPTH, D_MODEL), 0.02)
    ln2_b = nrm(ks[14], (DEPTH, D_MODEL), 0.02)
    return {"x": x, "p": p, "positions": positions, "w_in": w_in, "conv_w": conv_w,
            "ret_gn_w": ret_gn_w, "ret_gn_b": ret_gn_b, "w_out": w_out,
            "ln1_w": ln1_w, "ln1_b": ln1_b, "w_ff1": w_ff1, "w_ff2": w_ff2,
            "w_ple_gate": w_ple_gate, "w_ple_proj": w_ple_proj,
            "ln2_w": ln2_w, "ln2_b": ln2_b}


def reference(x, p, positions, w_in, conv_w, ret_gn_w, ret_gn_b, w_out, ln1_w, ln1_b,
              w_ff1, w_ff2, w_ple_gate, w_ple_proj, ln2_w, ln2_b):
    bsz, s, _ = x.shape
    cw, rw = CONV_WIDTH, RET_WIDTH
    split_at = [cw, 2 * cw, 3 * cw, 3 * cw + rw, 3 * cw + 2 * rw, 3 * cw + 3 * rw]
    for i in range(DEPTH):
        hcat = x @ w_in[i]
        b_gate, c_gate, hc, q, k, v, g = jnp.split(hcat, split_at, axis=-1)
        y_conv = b_gate * causal_short_conv(c_gate * hc, conv_w[i])
        q = rotary(q.reshape(bsz, s, RET_HEADS, RET_HEAD_DIM), positions)
        k = rotary(k.reshape(bsz, s, RET_HEADS, RET_HEAD_DIM), positions) * (RET_HEAD_DIM ** -0.5)
        v = v.reshape(bsz, s, RET_HEADS, RET_HEAD_DIM)
        o = chunkwise_retention(q, k, v)
        y_ret = jax.nn.silu(g) * head_group_norm(o, ret_gn_w[i], ret_gn_b[i])
        mix = jnp.concatenate([y_conv, y_ret], axis=-1) @ w_out[i]
        x = layer_norm(DEEPNORM_ALPHA * x + mix, ln1_w[i], ln1_b[i])
        ff = jnp.square(jax.nn.relu(x @ w_ff1[i])) @ w_ff2[i]
        ple = jax.nn.sigmoid(x @ w_ple_gate[i]) * (p[i] @ w_ple_proj[i])
        x = layer_norm(DEEPNORM_ALPHA * x + ff + ple, ln2_w[i], ln2_b[i])
    return x
```

```cpp
#include <hip/hip_runtime.h>
#include <cstdio>
#include <cstdint>

namespace nv {
constexpr int D_MODEL = 1024, BATCH = 8, SEQ = 2048, PLE_DIM = 256, CW = 512, RW = 512, RH = 4, RD = 128, D_FF = 4096, CHUNK = 128, IN_COLS = 3584;
constexpr float LN_EPS = 1e-5f, GN_EPS = 1e-5f;
constexpr float ALPHA = 1.189207115002721f;

__global__ void __launch_bounds__(256) gemm_f32(const float* __restrict__ A, const float* __restrict__ B, float* __restrict__ C, int M, int N, int K, int lda, int ldb, int ldc) {
    __shared__ float As[16][68];
    __shared__ float Bs[16][68];
    const int tx = threadIdx.x & 15, ty = threadIdx.x >> 4;
    const int m0 = blockIdx.y * 64, n0 = blockIdx.x * 64;
    float acc[4][4] = {};
    for (int k0 = 0; k0 < K; k0 += 16) {
        for (int i = threadIdx.x; i < 64 * 16; i += 256) { const int r = i >> 4, c = i & 15; As[c][r] = A[(size_t)(m0 + r) * lda + k0 + c]; }
        for (int i = threadIdx.x; i < 16 * 64; i += 256) { const int r = i >> 6, c = i & 63; Bs[r][c] = B[(size_t)(k0 + r) * ldb + n0 + c]; }
        __syncthreads();
#pragma unroll
        for (int k = 0; k < 16; ++k) {
            float a[4], b[4];
#pragma unroll
            for (int i = 0; i < 4; ++i) { a[i] = As[k][ty * 4 + i]; b[i] = Bs[k][tx * 4 + i]; }
#pragma unroll
            for (int i = 0; i < 4; ++i)
#pragma unroll
                for (int j = 0; j < 4; ++j) acc[i][j] = fmaf(a[i], b[j], acc[i][j]);
        }
        __syncthreads();
    }
#pragma unroll
    for (int i = 0; i < 4; ++i)
#pragma unroll
        for (int j = 0; j < 4; ++j) C[(size_t)(m0 + ty * 4 + i) * ldc + n0 + tx * 4 + j] = acc[i][j];
}

__global__ void conv_k(const float* __restrict__ HC, const float* __restrict__ cw, float* __restrict__ MIX) {
    const int idx = blockIdx.x * blockDim.x + threadIdx.x; if (idx >= SEQ * CW) return;
    const int t = idx / CW, c = idx % CW;
    float s = 0.f;
    for (int k = 0; k < 3; ++k) { const int tt = t - 2 + k; if (tt >= 0) s += cw[k * CW + c] * (HC[(size_t)tt * IN_COLS + CW + c] * HC[(size_t)tt * IN_COLS + 2 * CW + c]); }
    MIX[(size_t)t * D_MODEL + c] = HC[(size_t)t * IN_COLS + c] * s;
}
__global__ void rotary_k(float* __restrict__ HC, const int* __restrict__ pos) {
    const int idx = blockIdx.x * blockDim.x + threadIdx.x; if (idx >= SEQ * 2 * RH * 64) return;
    const int i = idx % 64, hh = (idx / 64) % (2 * RH), t = idx / (64 * 2 * RH);
    const int isk = hh / RH, h = hh % RH;
    const float inv_freq = powf(10000.0f, -(float)i * 2.0f / 128.0f);
    const float ang = (float)pos[t] * inv_freq;
    const float c = cosf(ang), s = sinf(ang);
    float* p = HC + (size_t)t * IN_COLS + 3 * CW + isk * RW + h * RD;
    const float x1 = p[i], x2 = p[i + 64];
    const float sc = isk ? 0.08838834764831845f : 1.0f;
    p[i] = (x1 * c - x2 * s) * sc; p[i + 64] = (x2 * c + x1 * s) * sc;
}
__global__ void __launch_bounds__(1024) retention_k(const float* __restrict__ HC, float* __restrict__ O) {
    const int h = blockIdx.x, e = threadIdx.x & 127, g = threadIdx.x >> 7;
    __shared__ float part[8][128];
    __shared__ float qs[128], ks[128];
    const float gamma = 1.0f - exp2f(-5.0f - (float)h);
    float S[16];
#pragma unroll
    for (int j = 0; j < 16; ++j) S[j] = 0.f;
    for (int t = 0; t < SEQ; ++t) {
        const float* row = HC + (size_t)t * IN_COLS + 3 * CW + h * RD;
        if (threadIdx.x < 128) qs[threadIdx.x] = row[threadIdx.x];
        else if (threadIdx.x < 256) ks[threadIdx.x - 128] = row[RW + threadIdx.x - 128];
        const float v = row[2 * RW + e];
        __syncthreads();
        float o = 0.f;
#pragma unroll
        for (int j = 0; j < 16; ++j) { const int d = g * 16 + j; S[j] = S[j] * gamma + ks[d] * v; o += qs[d] * S[j]; }
        part[g][e] = o;
        __syncthreads();
        if (g == 0) { float s = 0.f;
#pragma unroll
            for (int j = 0; j < 8; ++j) s += part[j][e];
            O[(size_t)t * RW + h * RD + e] = s; }
    }
}
__global__ void __launch_bounds__(128) gn_gate_k(const float* __restrict__ O, const float* __restrict__ HC, const float* __restrict__ gw, const float* __restrict__ gb, float* __restrict__ MIX) {
    const int t = blockIdx.x / RH, h = blockIdx.x % RH, e = threadIdx.x;
    __shared__ float red[128];
    const float o = O[(size_t)t * RW + h * RD + e];
    red[e] = o; __syncthreads();
    for (int s = 64; s > 0; s >>= 1) { if (e < s) red[e] += red[e + s]; __syncthreads(); }
    const float mu = red[0] / 128.f; __syncthreads();
    const float d = o - mu; red[e] = d * d; __syncthreads();
    for (int s = 64; s > 0; s >>= 1) { if (e < s) red[e] += red[e + s]; __syncthreads(); }
    const float var = red[0] / 128.f;
    const float y = d * rsqrtf(var + GN_EPS) * gw[h * RD + e] + gb[h * RD + e];
    const float gt = HC[(size_t)t * IN_COLS + 3 * CW + 3 * RW + h * RD + e];
    MIX[(size_t)t * D_MODEL + CW + h * RD + e] = gt / (1.f + expf(-gt)) * y;
}
__global__ void __launch_bounds__(256) ln_k(const float* __restrict__ xin, const float* __restrict__ a, const float* __restrict__ gate, const float* __restrict__ proj,
                                            const float* __restrict__ w, const float* __restrict__ b, float* __restrict__ out) {
    const int t = blockIdx.x;
    __shared__ float red[256];
    float v[4]; float s = 0.f;
#pragma unroll
    for (int j = 0; j < 4; ++j) { const int c = threadIdx.x + 256 * j; const size_t i = (size_t)t * D_MODEL + c;
        float val = ALPHA * xin[i] + a[i]; if (gate) val += proj[i] / (1.f + expf(-gate[i])); v[j] = val; s += val; }
    red[threadIdx.x] = s; __syncthreads();
    for (int st = 128; st > 0; st >>= 1) { if (threadIdx.x < st) red[threadIdx.x] += red[threadIdx.x + st]; __syncthreads(); }
    const float mu = red[0] / 1024.f; __syncthreads();
    float q = 0.f;
#pragma unroll
    for (int j = 0; j < 4; ++j) { v[j] -= mu; q += v[j] * v[j]; }
    red[threadIdx.x] = q; __syncthreads();
    for (int st = 128; st > 0; st >>= 1) { if (threadIdx.x < st) red[threadIdx.x] += red[threadIdx.x + st]; __syncthreads(); }
    const float rstd = rsqrtf(red[0] / 1024.f + LN_EPS);
#pragma unroll
    for (int j = 0; j < 4; ++j) { const int c = threadIdx.x + 256 * j; out[(size_t)t * D_MODEL + c] = v[j] * rstd * w[c] + b[c]; }
}
__global__ void sqrelu_k(float* __restrict__ H, size_t n) { const size_t i = (size_t)blockIdx.x * blockDim.x + threadIdx.x; if (i < n) { const float v = fmaxf(H[i], 0.f); H[i] = v * v; } }

constexpr size_t N_HC = (size_t)SEQ * IN_COLS, N_MIX = (size_t)SEQ * D_MODEL, N_O = (size_t)SEQ * RW, N_T1 = (size_t)SEQ * D_MODEL, N_X1 = (size_t)SEQ * D_MODEL, N_H = (size_t)SEQ * D_FF;
constexpr size_t OFF_HC = 0, OFF_MIX = OFF_HC + N_HC, OFF_O = OFF_MIX + N_MIX, OFF_T1 = OFF_O + N_O, OFF_X1 = OFF_T1 + N_T1, OFF_H = OFF_X1 + N_X1, OFF_FF = OFF_H + N_H, OFF_GT = OFF_FF + N_T1, OFF_PR = OFF_GT + N_T1, OFF_END = OFF_PR + N_T1;

static void gemm(const float* A, const float* B, float* C, int M, int N, int K, int lda, int ldb, int ldc, hipStream_t s) {
    hipLaunchKernelGGL(gemm_f32, dim3(N / 64, M / 64), dim3(256), 0, s, A, B, C, M, N, K, lda, ldb, ldc);
}
static void forward(void* const* d_in, float* out, float* ws, hipStream_t s) {
    const float* x = (const float*)d_in[0]; const float* p = (const float*)d_in[1]; const int* pos = (const int*)d_in[2];
    const float* w_in = (const float*)d_in[3]; const float* conv_w = (const float*)d_in[4]; const float* gnw = (const float*)d_in[5]; const float* gnb = (const float*)d_in[6];
    const float* w_out = (const float*)d_in[7]; const float* ln1w = (const float*)d_in[8]; const float* ln1b = (const float*)d_in[9];
    const float* w_ff1 = (const float*)d_in[10]; const float* w_ff2 = (const float*)d_in[11]; const float* w_gate = (const float*)d_in[12]; const float* w_proj = (const float*)d_in[13];
    const float* ln2w = (const float*)d_in[14]; const float* ln2b = (const float*)d_in[15];
    float *HC = ws + OFF_HC, *MIX = ws + OFF_MIX, *O = ws + OFF_O, *T1 = ws + OFF_T1, *X1 = ws + OFF_X1, *H = ws + OFF_H, *FF = ws + OFF_FF, *GT = ws + OFF_GT, *PR = ws + OFF_PR;
    for (int b = 0; b < BATCH; ++b) {
        const float* xb = x + (size_t)b * SEQ * D_MODEL; const float* pb = p + (size_t)b * SEQ * PLE_DIM; float* ob = out + (size_t)b * SEQ * D_MODEL;
        gemm(xb, w_in, HC, SEQ, IN_COLS, D_MODEL, D_MODEL, IN_COLS, IN_COLS, s);
        hipLaunchKernelGGL(conv_k, dim3(SEQ * CW / 256), dim3(256), 0, s, HC, conv_w, MIX);
        hipLaunchKernelGGL(rotary_k, dim3(SEQ * 2 * RH * 64 / 256), dim3(256), 0, s, HC, pos + (size_t)b * SEQ);
        hipLaunchKernelGGL(retention_k, dim3(RH), dim3(1024), 0, s, HC, O);
        hipLaunchKernelGGL(gn_gate_k, dim3(SEQ * RH), dim3(128), 0, s, O, HC, gnw, gnb, MIX);
        gemm(MIX, w_out, T1, SEQ, D_MODEL, D_MODEL, D_MODEL, D_MODEL, D_MODEL, s);
        hipLaunchKernelGGL(ln_k, dim3(SEQ), dim3(256), 0, s, xb, T1, (const float*)nullptr, (const float*)nullptr, ln1w, ln1b, X1);
        gemm(X1, w_ff1, H, SEQ, D_FF, D_MODEL, D_MODEL, D_FF, D_FF, s);
        hipLaunchKernelGGL(sqrelu_k, dim3((unsigned)(N_H / 256)), dim3(256), 0, s, H, N_H);
        gemm(H, w_ff2, FF, SEQ, D_MODEL, D_FF, D_FF, D_MODEL, D_MODEL, s);
        gemm(X1, w_gate, GT, SEQ, D_MODEL, D_MODEL, D_MODEL, D_MODEL, D_MODEL, s);
        gemm(pb, w_proj, PR, SEQ, D_MODEL, PLE_DIM, PLE_DIM, D_MODEL, D_MODEL, s);
        hipLaunchKernelGGL(ln_k, dim3(SEQ), dim3(256), 0, s, X1, FF, GT, PR, ln2w, ln2b, ob);
    }
}
}

extern "C" void kernel_launch(void* const* d_in, const int* in_sizes, int n_in, void* d_out, int out_size, void* d_ws, size_t ws_size, hipStream_t stream) {
    (void)in_sizes; (void)n_in; (void)out_size; (void)ws_size;
    nv::forward(d_in, (float*)d_out, (float*)d_ws, stream);
}
```
